# Optimizing an MI355X kernel written in HIP

```python
import jax, jax.numpy as jnp
from jax import lax
import numpy as np

D_MODEL = 1024
BATCH = 2
SEQ = 8192
DEPTH = 1

D_MIX = D_MODEL
D_CONV = D_MIX // 2
CONV_KERNEL = 31
D_GLA_V = D_MIX - D_CONV
D_GLA_K = D_GLA_V // 2
GLA_HEADS = 4
HEAD_K = D_GLA_K // GLA_HEADS
HEAD_V = D_GLA_V // GLA_HEADS
GATE_RANK = 16
GATE_TAU = 16.0
CHUNK = 64
D_FF = ((8 * D_MODEL + 3 * 256 - 1) // (3 * 256)) * 256
D_IN = 2 * D_CONV + 2 * D_GLA_K + 2 * D_GLA_V + GATE_RANK
EPS = 1e-6

kernel_name = "hybrid_conv_gla_adaln_block"


def rms_norm(x, g):
    xf = x.astype(jnp.float32)
    y = xf * lax.rsqrt(jnp.mean(xf * xf, axis=-1, keepdims=True) + EPS)
    return (y * g.astype(jnp.float32)).astype(x.dtype)


def layer_norm(x, g, b):
    xf = x.astype(jnp.float32)
    mu = jnp.mean(xf, axis=-1, keepdims=True)
    var = jnp.mean(jnp.square(xf - mu), axis=-1, keepdims=True)
    y = (xf - mu) * lax.rsqrt(var + EPS)
    return (y * g.astype(jnp.float32) + b.astype(jnp.float32)).astype(x.dtype)


def causal_depthwise_conv(u, w, bias):
    k = w.shape[0]
    out = lax.conv_general_dilated(
        u, w[:, None, :], window_strides=(1,), padding=[(k - 1, 0)],
        dimension_numbers=('NWC', 'WIO', 'NWC'), feature_group_count=u.shape[-1])
    return out + bias


def gla_chunked(q, k, v, log_a):
    out_dtype = v.dtype
    b_sz, t_len, n_h, dk = q.shape
    dv = v.shape[-1]
    n_chunks = t_len // CHUNK

    def to_chunks(t):
        return t.astype(jnp.float32).reshape(b_sz, n_chunks, CHUNK, n_h, t.shape[-1]).transpose(1, 0, 3, 2, 4)

    qc, kc, vc, ac = to_chunks(q), to_chunks(k), to_chunks(v), to_chunks(log_a)
    causal = jnp.tril(jnp.ones((CHUNK, CHUNK), dtype=bool))[:, :, None]

    def step(state, inp):
        qi, ki, vi, ai = inp
        cum = jnp.cumsum(ai, axis=2)
        o_inter = jnp.einsum('bhld,bhde->bhle', qi * jnp.exp(cum), state)
        diff = cum[:, :, :, None, :] - cum[:, :, None, :, :]
        decay = jnp.exp(jnp.where(causal, diff, -jnp.inf))
        scores = jnp.einsum('bhid,bhijd,bhjd->bhij', qi, decay, ki)
        o_intra = jnp.einsum('bhij,bhje->bhie', scores, vi)
        cum_last = cum[:, :, -1:, :]
        new_state = jnp.exp(cum_last[:, :, 0, :, None]) * state + jnp.einsum(
            'bhld,bhle->bhde', ki * jnp.exp(cum_last - cum), vi)
        return new_state, o_inter + o_intra

    s0 = jnp.zeros((b_sz, n_h, dk, dv), jnp.float32)
    _, o = lax.scan(step, s0, (qc, kc, vc, ac))
    return o.transpose(1, 0, 3, 2, 4).reshape(b_sz, t_len, n_h, dv).astype(out_dtype)


def setup_inputs(seed: int = 0) -> dict:
    key = jax.random.key(seed)
    ks = jax.random.split(key, 20)
    f32 = jnp.float32

    def nrm(k, shape, scale):
        return jax.random.normal(k, shape, f32) * scale

    return {
        "x": nrm(ks[0], (BATCH, SEQ, D_MODEL), 1.0),
        "c": nrm(ks[1], (BATCH, D_MODEL), 1.0),
        "w_ada": nrm(ks[2], (DEPTH, D_MODEL, 6 * D_MODEL), D_MODEL ** -0.5),
        "b_ada": nrm(ks[3], (DEPTH, 6 * D_MODEL), 0.02),
        "g_mix": 1.0 + nrm(ks[4], (DEPTH, D_MODEL), 0.02),
        "w_in": nrm(ks[5], (DEPTH, D_MODEL, D_IN), D_MODEL ** -0.5),
        "conv_w": nrm(ks[6], (DEPTH, CONV_KERNEL, D_CONV), CONV_KERNEL ** -0.5),
        "conv_b": nrm(ks[7], (DEPTH, D_CONV), 0.02),
        "ln_g": 1.0 + nrm(ks[8], (DEPTH, D_CONV), 0.02),
        "ln_b": nrm(ks[9], (DEPTH, D_CONV), 0.02),
        "w_a2": nrm(ks[10], (DEPTH, GATE_RANK, D_GLA_K), GATE_RANK ** -0.5),
        "b_a2": nrm(ks[11], (DEPTH, D_GLA_K), 0.02),
        "gla_norm_g": 1.0 + nrm(ks[12], (DEPTH, HEAD_V), 0.02),
        "w_out": nrm(ks[13], (DEPTH, D_MIX, D_MODEL), D_MIX ** -0.5),
        "g_ffn": 1.0 + nrm(ks[14], (DEPTH, D_MODEL), 0.02),
        "w_ffn_in": nrm(ks[15], (DEPTH, D_MODEL, 2 * D_FF), D_MODEL ** -0.5),
        "w_ffn_out": nrm(ks[16], (DEPTH, D_FF, D_MODEL), D_FF ** -0.5),
        "w_ada_final": nrm(ks[17], (D_MODEL, 2 * D_MODEL), D_MODEL ** -0.5),
        "b_ada_final": nrm(ks[18], (2 * D_MODEL,), 0.02),
        "g_final": 1.0 + nrm(ks[19], (D_MODEL,), 0.02),
    }


def reference(x, c, w_ada, b_ada, g_mix, w_in, conv_w, conv_b, ln_g, ln_b, w_a2, b_a2,
              gla_norm_g, w_out, g_ffn, w_ffn_in, w_ffn_out, w_ada_final, b_ada_final, g_final):
    b_sz, t_len, _ = x.shape
    c_act = jax.nn.silu(c)
    split_pts = [D_CONV, 2 * D_CONV, 2 * D_CONV + D_GLA_K, 2 * D_CONV + 2 * D_GLA_K,
                 2 * D_CONV + 2 * D_GLA_K + D_GLA_V, 2 * D_CONV + 2 * D_GLA_K + 2 * D_GLA_V]

    for l in range(DEPTH):
        mod = (c_act @ w_ada[l] + b_ada[l])[:, None, :]
        sh1, sc1, gt1, sh2, sc2, gt2 = jnp.split(mod, 6, axis=-1)

        h = rms_norm(x, g_mix[l]) * (1.0 + sc1) + sh1
        proj = h @ w_in[l]
        cv, cg, q, k, v, og, a_low = jnp.split(proj, split_pts, axis=-1)

        u = cv * jax.nn.sigmoid(cg)
        u = causal_depthwise_conv(u, conv_w[l], conv_b[l])
        y_conv = jax.nn.silu(layer_norm(u, ln_g[l], ln_b[l]))

        log_a = jax.nn.log_sigmoid(a_low @ w_a2[l] + b_a2[l]) / GATE_TAU
        qh = q.reshape(b_sz, t_len, GLA_HEADS, HEAD_K) * (HEAD_K ** -0.5)
        kh = k.reshape(b_sz, t_len, GLA_HEADS, HEAD_K)
        vh = v.reshape(b_sz, t_len, GLA_HEADS, HEAD_V)
        ah = log_a.reshape(b_sz, t_len, GLA_HEADS, HEAD_K)
        o = gla_chunked(qh, kh, vh, ah)
        o = rms_norm(o, gla_norm_g[l]).reshape(b_sz, t_len, D_GLA_V)
        y_gla = o * jax.nn.silu(og)

        mix = jnp.concatenate([y_conv, y_gla], axis=-1) @ w_out[l]
        x = x + gt1 * mix

        h = rms_norm(x, g_ffn[l]) * (1.0 + sc2) + sh2
        gate, up = jnp.split(h @ w_ffn_in[l], 2, axis=-1)
        x = x + gt2 * ((jax.nn.silu(gate) * up) @ w_ffn_out[l])

    fmod = (c_act @ w_ada_final + b_ada_final)[:, None, :]
    shf, scf = jnp.split(fmod, 2, axis=-1)
    return rms_norm(x, g_final) * (1.0 + scf) + shf
```

```cpp
#include <hip/hip_runtime.h>
#include <cstdio>
#include <cstdint>
namespace pg8 {
#define PG8_LAS __attribute__((address_space(3)))
typedef unsigned short bf16_t;
typedef short bf16x8 __attribute__((ext_vector_type(8)));
typedef float f32x4 __attribute__((ext_vector_type(4)));
typedef unsigned u32x4 __attribute__((ext_vector_type(4)));
constexpr int BM = 256, BK = 64, HALF = 128, HTB = HALF * BK * 2  , STAGE_BYTES = 8 * HTB, NXCD = 8, WGM = 8;

__host__ __device__ __forceinline__ int lds_byte(int r, int c) { const int st = (r >> 4) * 2 + (c >> 5), rr = r & 15, cc = c & 31, ob = rr * 64 + cc * 2; return st * 1024 + (ob ^ (((ob >> 9) & 1) << 5)); }
__host__ __device__ __forceinline__ void stage_rc(int b, int& R, int& C) { const int st = b / 1024, sb = b % 1024, swz = sb ^ (((sb >> 9) & 1) << 5); R = (st >> 1) * 16 + swz / 64; C = (st & 1) * 32 + (swz % 64) / 2; }
__host__ __device__ __forceinline__ int perm32(int rho) { const int n = rho >> 4, i = rho & 15; return 8 * (i >> 2) + 4 * n + (i & 3); }

struct Unit { int pm, pn; };
struct Gemm { const bf16_t* A; const bf16_t* Bt; int M, N, K; };

struct StaticOrder {
    int nM, nN, nwg, G, c;
    __host__ __device__ void init(int M, int N, int G_, int c_) { nM = M / BM; nN = N / BM; nwg = nM * nN; G = G_; c = c_; }
    __host__ __device__ bool next(int i, Unit& u) const {
        const long L = (long)i * G + c; if (L >= nwg) return false;
        int wgid = (int)L; { const int q = nwg / NXCD, r = nwg % NXCD, xcd = wgid % NXCD, off = wgid / NXCD; wgid = (xcd < r ? xcd * (q + 1) : r * (q + 1) + (xcd - r) * q) + off; }
        const int nig = WGM * nN, gid = wgid / nig, fm = gid * WGM, gsz = (nM - fm) < WGM ? (nM - fm) : WGM;
        u.pm = fm + ((wgid % nig) % gsz); u.pn = (wgid % nig) / gsz; return true;
    }
    __device__ __forceinline__ void a_ready(const Unit&) const {}
    __device__ __forceinline__ void done(const Unit&) const {}
};

__device__ __forceinline__ unsigned cvt_pk_bf16(float lo, float hi) { unsigned r; asm volatile("v_cvt_pk_bf16_f32 %0, %1, %2" : "=v"(r) : "v"(lo), "v"(hi)); return r; }
__device__ __forceinline__ float sigm(float x) { return __builtin_amdgcn_rcpf(1.0f + __expf(-x)); }
struct EpiProj {
    static constexpr bool PERM = true, AFTER_DRAIN = false;
    bf16_t *U, *QK; size_t tstride;
    __device__ __forceinline__ void operator()(const f32x4 (&acc)[2][2][4][2], const Unit& u, int wr, int wc, int fr, int fq) const {
        const int row0 = u.pm * BM + wr * 64 + fr;
        if (u.pn < 4) {
            const int col0 = u.pn * 128 + wc * 32 + 8 * fq;
#pragma unroll
            for (int ai = 0; ai < 2; ++ai)
#pragma unroll
                for (int m = 0; m < 4; ++m) { bf16_t* rowp = U + (size_t)(row0 + ai * HALF + m * 16) * 512 + col0;
                    f32x4 a0 = acc[ai][0][m][0], a1 = acc[ai][0][m][1]; const f32x4 g0 = acc[ai][1][m][0], g1 = acc[ai][1][m][1];
#pragma unroll
                    for (int i = 0; i < 4; ++i) { a0[i] *= sigm(g0[i]); a1[i] *= sigm(g1[i]); }
                    u32x4 w; w.x = cvt_pk_bf16(a0[0], a0[1]); w.y = cvt_pk_bf16(a0[2], a0[3]); w.z = cvt_pk_bf16(a1[0], a1[1]); w.w = cvt_pk_bf16(a1[2], a1[3]);
                    *(u32x4*)rowp = w; }
        } else {
            const int t = (u.pn - 4) >> 1; bf16_t* base = QK + (size_t)t * tstride;
            const int col0 = ((u.pn - 4) & 1) * 256 + wc * 32 + 8 * fq;
#pragma unroll
            for (int ai = 0; ai < 2; ++ai)
#pragma unroll
                for (int m = 0; m < 4; ++m) { bf16_t* rowp = base + (size_t)(row0 + ai * HALF + m * 16) * 512 + col0;
#pragma unroll
                    for (int bj = 0; bj < 2; ++bj) { const f32x4 v0 = acc[ai][bj][m][0], v1 = acc[ai][bj][m][1];
                        u32x4 w; w.x = cvt_pk_bf16(v0[0], v0[1]); w.y = cvt_pk_bf16(v0[2], v0[3]); w.z = cvt_pk_bf16(v1[0], v1[1]); w.w = cvt_pk_bf16(v1[2], v1[3]);
                        *(u32x4*)(rowp + bj * HALF) = w; } }
        }
    }
};
struct EpiSwiGLU {
    static constexpr bool PERM = true, AFTER_DRAIN = false;
    bf16_t* H; int ldh;
    __device__ __forceinline__ void operator()(const f32x4 (&acc)[2][2][4][2], const Unit& u, int wr, int wc, int fr, int fq) const {
        const int row0 = u.pm * BM + wr * 64 + fr; const int col0 = u.pn * 128 + wc * 32 + 8 * fq;
#pragma unroll
        for (int ai = 0; ai < 2; ++ai)
#pragma unroll
            for (int m = 0; m < 4; ++m) { bf16_t* rowp = H + (size_t)(row0 + ai * HALF + m * 16) * ldh + col0;
                const f32x4 g0 = acc[ai][0][m][0], g1 = acc[ai][0][m][1], u0 = acc[ai][1][m][0], u1 = acc[ai][1][m][1]; f32x4 a0, a1;
#pragma unroll
                for (int i = 0; i < 4; ++i) { a0[i] = g0[i] * sigm(g0[i]) * u0[i]; a1[i] = g1[i] * sigm(g1[i]) * u1[i]; }
                u32x4 w; w.x = cvt_pk_bf16(a0[0], a0[1]); w.y = cvt_pk_bf16(a0[2], a0[3]); w.z = cvt_pk_bf16(a1[0], a1[1]); w.w = cvt_pk_bf16(a1[2], a1[3]);
                *(u32x4*)rowp = w; }
    }
};
struct EpiResid {
    static constexpr bool PERM = false, AFTER_DRAIN = false;
    const float* base; float* out; const float* gate; int gstride;
    __device__ __forceinline__ void operator()(const f32x4 (&acc)[2][2][4][2], const Unit& u, int wr, int wc, int fr, int fq) const {
        const int col0 = u.pn * BM + wc * 32 + 4 * fq; const float* g = gate + (u.pm >= 32 ? gstride : 0);
        f32x4 gv[2][2];
#pragma unroll
        for (int bj = 0; bj < 2; ++bj)
#pragma unroll
            for (int n = 0; n < 2; ++n) gv[bj][n] = *(const f32x4*)(g + col0 + bj * HALF + n * 16);
#pragma unroll
        for (int ai = 0; ai < 2; ++ai)
#pragma unroll
            for (int m = 0; m < 4; ++m) { const size_t off = (size_t)(u.pm * BM + ai * HALF + wr * 64 + m * 16 + fr) * 1024 + col0;
#pragma unroll
                for (int bj = 0; bj < 2; ++bj)
#pragma unroll
                    for (int n = 0; n < 2; ++n) { const f32x4 bs = *(const f32x4*)(base + off + bj * HALF + n * 16); *(f32x4*)(out + off + bj * HALF + n * 16) = bs + gv[bj][n] * acc[ai][bj][m][n]; }
                if (m & 1) asm volatile("" ::: "memory"); }
    }
};
template <class Epi, class Sched, bool ALIGN_EPI = false, bool SP2 = false>
__device__ __forceinline__ void gemm_phase(PG8_LAS unsigned char* lds, const Gemm g, const Sched& S, const Epi& E) {
    const int tid = threadIdx.x, wid = __builtin_amdgcn_readfirstlane(tid >> 6), lane = tid & 63, wr = wid >> 2, wc = wid & 3, fr = lane & 15, fq = lane >> 4;
    const int K = g.K, nt = K / BK;
    unsigned voffA[2], voffB[2];
#pragma unroll
    for (int i = 0; i < 2; ++i) { int R, C; stage_rc(tid * 16 + i * 8192, R, C); const int Rb = Epi::PERM ? ((R & ~31) + perm32(R & 31)) : R;
        voffA[i] = (unsigned)(R * K + C) * 2u; voffB[i] = (unsigned)(Rb * K + C) * 2u; }
    const size_t kstep = (size_t)(BK * 2);
    const size_t hstep = (size_t)HALF * K * 2;
    const size_t tstep = 2 * hstep;
    const unsigned ldsw = (unsigned)wid * 1024u;
    const int aoff = lds_byte(wr * 64 + fr, fq * 8), boff = lds_byte(wc * 32 + fr, fq * 8);
#define PG8_SA(b, h) (((b) * 2 + (h)) * HTB)
#define PG8_SB(b, h) ((4 + (b) * 2 + (h)) * HTB)
#define PG8_STAGE(bufoff, gbase, voff) do { _Pragma("unroll") for (int _i = 0; _i < 2; ++_i) \
        __builtin_amdgcn_global_load_lds((const unsigned*)((const char*)(gbase) + (voff)[_i]), (PG8_LAS unsigned*)(lds + (bufoff) + ldsw + _i * 8192), 16, 0, 0); } while (0)
#define PG8_LDA(dst, b, h) do { _Pragma("unroll") for (int m = 0; m < 4; ++m) _Pragma("unroll") for (int k = 0; k < 2; ++k) dst[m][k] = *(const PG8_LAS bf16x8*)(lds + PG8_SA(b, h) + aoff + m * 2048 + k * 1024); } while (0)
#define PG8_LDB(dst, b, h) do { _Pragma("unroll") for (int n = 0; n < 2; ++n) _Pragma("unroll") for (int k = 0; k < 2; ++k) dst[n][k] = *(const PG8_LAS bf16x8*)(lds + PG8_SB(b, h) + boff + n * 2048 + k * 1024); } while (0)
#define PG8_MMA(ai, bj, At, Bt) do { __builtin_amdgcn_s_setprio(1); _Pragma("unroll") for (int m = 0; m < 4; ++m) _Pragma("unroll") for (int n = 0; n < 2; ++n) _Pragma("unroll") for (int k = 0; k < 2; ++k) \
        acc[ai][bj][m][n] = __builtin_amdgcn_mfma_f32_16x16x32_bf16(Bt[n][k], At[m][k], acc[ai][bj][m][n], 0, 0, 0); __builtin_amdgcn_s_setprio(0); } while (0)
#define PG8_WAIT_V(n) asm volatile("s_waitcnt vmcnt(" #n ")" ::: "memory")
#define PG8_WAIT_L(n) asm volatile("s_waitcnt lgkmcnt(" #n ")" ::: "memory")
#define PG8_BAR __builtin_amdgcn_s_barrier()
#define PG8_SCHED __builtin_amdgcn_sched_barrier(0)
    Unit cur, nxt; int ui = 0;
    if (!S.next(0, cur)) return;
    f32x4 acc[2][2][4][2];
#pragma unroll
    for (int a = 0; a < 2; ++a)
#pragma unroll
        for (int b = 0; b < 2; ++b)
#pragma unroll
            for (int m = 0; m < 4; ++m)
#pragma unroll
                for (int n = 0; n < 2; ++n) acc[a][b][m][n] = (f32x4){0.f, 0.f, 0.f, 0.f};
    bf16x8 At[4][2], B0[2][2], B1[2][2];
    const char* cA = (const char*)g.A + (size_t)cur.pm * tstep; const char* cB = (const char*)g.Bt + (size_t)cur.pn * tstep;
    S.a_ready(cur);
    if constexpr (SP2) {
        PG8_STAGE(PG8_SB(0, 0), cB, voffB); PG8_STAGE(PG8_SB(0, 1), cB + hstep, voffB); PG8_STAGE(PG8_SA(0, 0), cA, voffA); PG8_STAGE(PG8_SA(0, 1), cA + hstep, voffA);
        if (wr == 1) PG8_BAR;
        PG8_WAIT_V(2); PG8_BAR;
        PG8_STAGE(PG8_SB(1, 0), cB + kstep, voffB); PG8_STAGE(PG8_SA(1, 0), cA + kstep, voffA); PG8_STAGE(PG8_SB(1, 1), cB + hstep + kstep, voffB);
        PG8_WAIT_V(6); PG8_BAR;
    } else {
        PG8_STAGE(PG8_SB(0, 0), cB, voffB); PG8_STAGE(PG8_SA(0, 0), cA, voffA); PG8_STAGE(PG8_SB(0, 1), cB + hstep, voffB); PG8_STAGE(PG8_SA(0, 1), cA + hstep, voffA);
        if (wr == 1) PG8_BAR;
        PG8_WAIT_V(4); PG8_BAR;
        PG8_STAGE(PG8_SB(1, 0), cB + kstep, voffB); PG8_STAGE(PG8_SA(1, 0), cA + kstep, voffA); PG8_STAGE(PG8_SB(1, 1), cB + hstep + kstep, voffB);
        PG8_WAIT_V(6); PG8_BAR;
    }
    for (;;) {
        const bool has_next = S.next(ui + 1, nxt);
        const char* nA = has_next ? (const char*)g.A + (size_t)nxt.pm * tstep : cA; const char* nB = has_next ? (const char*)g.Bt + (size_t)nxt.pn * tstep : cB;
        for (int t = 0; t < nt; t += 2) {
            const bool last = (t == nt - 2);
            const char* a1 = cA + (size_t)(t + 1) * kstep;
            const char* a2 = last ? nA : cA + (size_t)(t + 2) * kstep; const char* b2 = last ? nB : cB + (size_t)(t + 2) * kstep;
            const char* a3 = a2 + kstep; const char* b3 = b2 + kstep;
            if (last && has_next) S.a_ready(nxt);
            if constexpr (SP2) {
            PG8_LDB(B0, 0, 0); PG8_LDB(B1, 0, 1); PG8_SCHED; PG8_LDA(At, 0, 0); PG8_STAGE(PG8_SA(1, 1), a1 + hstep, voffA);
            PG8_WAIT_V(8); PG8_WAIT_L(0); PG8_BAR; PG8_MMA(0, 0, At, B0); PG8_MMA(0, 1, At, B1); PG8_BAR; PG8_SCHED;
            PG8_LDA(At, 0, 1); PG8_STAGE(PG8_SB(0, 0), b2, voffB); PG8_STAGE(PG8_SB(0, 1), b2 + hstep, voffB); PG8_STAGE(PG8_SA(0, 0), a2, voffA);
            PG8_WAIT_V(8); PG8_WAIT_L(0); PG8_BAR; PG8_MMA(1, 0, At, B0); PG8_MMA(1, 1, At, B1); PG8_BAR; PG8_SCHED;
            PG8_LDB(B0, 1, 0); PG8_LDB(B1, 1, 1); PG8_SCHED; PG8_LDA(At, 1, 0); PG8_STAGE(PG8_SA(0, 1), a2 + hstep, voffA);
            PG8_WAIT_V(8); PG8_WAIT_L(0); PG8_BAR; PG8_MMA(0, 0, At, B0); PG8_MMA(0, 1, At, B1); PG8_BAR; PG8_SCHED;
            PG8_LDA(At, 1, 1); PG8_STAGE(PG8_SB(1, 0), b3, voffB); PG8_STAGE(PG8_SB(1, 1), b3 + hstep, voffB); PG8_STAGE(PG8_SA(1, 0), a3, voffA);
            PG8_WAIT_V(8); PG8_WAIT_L(0); PG8_BAR; PG8_MMA(1, 0, At, B0); PG8_MMA(1, 1, At, B1); PG8_BAR; PG8_SCHED;
            } else {
            PG8_LDB(B0, 0, 0); PG8_SCHED; PG8_LDA(At, 0, 0); PG8_STAGE(PG8_SA(1, 1), a1 + hstep, voffA);
            PG8_WAIT_L(8); PG8_BAR; PG8_WAIT_L(0); PG8_MMA(0, 0, At, B0); PG8_BAR; PG8_SCHED;
            PG8_LDB(B1, 0, 1); PG8_STAGE(PG8_SB(0, 0), b2, voffB);
            PG8_BAR; PG8_WAIT_L(0); PG8_MMA(0, 1, At, B1); PG8_BAR;
            PG8_LDA(At, 0, 1); PG8_STAGE(PG8_SA(0, 0), a2, voffA);
            PG8_BAR; PG8_WAIT_L(0); PG8_MMA(1, 0, At, B0); PG8_BAR; PG8_SCHED;
            PG8_STAGE(PG8_SB(0, 1), b2 + hstep, voffB);
            PG8_WAIT_V(6); PG8_BAR; PG8_MMA(1, 1, At, B1); PG8_BAR;
            PG8_LDB(B0, 1, 0); PG8_SCHED; PG8_LDA(At, 1, 0); PG8_STAGE(PG8_SA(0, 1), a2 + hstep, voffA);
            PG8_WAIT_L(8); PG8_BAR; PG8_WAIT_L(0); PG8_MMA(0, 0, At, B0); PG8_BAR; PG8_SCHED;
            PG8_LDB(B1, 1, 1); PG8_STAGE(PG8_SB(1, 0), b3, voffB);
            PG8_BAR; PG8_WAIT_L(0); PG8_MMA(0, 1, At, B1); PG8_BAR;
            PG8_LDA(At, 1, 1); PG8_STAGE(PG8_SA(1, 0), a3, voffA);
            PG8_BAR; PG8_WAIT_L(0); PG8_MMA(1, 0, At, B0); PG8_BAR; PG8_SCHED;
            PG8_STAGE(PG8_SB(1, 1), b3 + hstep, voffB);
            PG8_WAIT_V(6); PG8_BAR; PG8_MMA(1, 1, At, B1); PG8_BAR;
            }
        }
        if constexpr (ALIGN_EPI) { if (wr == 0) PG8_BAR; }
        if constexpr (!Epi::AFTER_DRAIN) { E(acc, cur, wr, wc, fr, fq); S.done(cur); }
        if (!has_next) break;
#pragma unroll
        for (int a = 0; a < 2; ++a)
#pragma unroll
            for (int b = 0; b < 2; ++b)
#pragma unroll
                for (int m = 0; m < 4; ++m)
#pragma unroll
                    for (int n = 0; n < 2; ++n) acc[a][b][m][n] = (f32x4){0.f, 0.f, 0.f, 0.f};
        cur = nxt; cA = nA; cB = nB; ++ui;
        if constexpr (ALIGN_EPI) { if (wr == 1) PG8_BAR; }
    }
    PG8_WAIT_V(0);
    if constexpr (!ALIGN_EPI) { if (wr == 0) PG8_BAR; }
    PG8_BAR;
    if constexpr (Epi::AFTER_DRAIN) { E.fused(acc, cur, wr, wc, fr, fq, lds, wid, lane); S.done(cur); }
#undef PG8_SA
#undef PG8_SB
#undef PG8_STAGE
#undef PG8_LDA
#undef PG8_LDB
#undef PG8_MMA
#undef PG8_WAIT_V
#undef PG8_WAIT_L
#undef PG8_BAR
#undef PG8_SCHED
}
}

#define MK_N_LAUNCHES 11
constexpr int NWAVES = 8;
#ifndef MK_N_LAUNCHES
#define MK_N_LAUNCHES 1
#endif
constexpr int N_PHASES = 11;
constexpr int N_LAUNCHES = MK_N_LAUNCHES;
constexpr int BATCH = 2, T = 8192, D = 1024, M = BATCH * T;
constexpr int DCONV = 512, CK = 31, DK = 256, DV = 512, NH = 4, HK = 64, HV = 128, RANK = 16, DFF = 2816, DIN = 2576;
constexpr int NPROJ = 2560;
constexpr int NMOD = 8192;
constexpr float EPS = 1e-6f;
constexpr size_t MiB = 1u << 20;
constexpr size_t WS_CTL = 0, CTL_ZERO_BYTES = 64 * 1024;
constexpr size_t WS_MOD = 1 * MiB;
constexpr size_t WS_WA = 1 * MiB + 64 * 1024;
constexpr size_t WS_WIN = 2 * MiB, WS_WOUT = 7 * MiB, WS_WF1 = 9 * MiB, WS_WF2 = 20 * MiB;
constexpr size_t WS_ALOW = 26 * MiB;
constexpr size_t WS_DEC = 27 * MiB;
constexpr size_t WS_XN = 32 * MiB;
constexpr size_t WS_U = 64 * MiB, WS_QK = 80 * MiB, WS_V = 96 * MiB, WS_OG = 112 * MiB;
constexpr size_t WS_KV = 128 * MiB;
constexpr size_t WS_Y = 160 * MiB;
constexpr size_t WS_H = 64 * MiB;
constexpr size_t WS_END = 192 * MiB;
static_assert(WS_H + (size_t)M * DFF * 2 <= WS_Y && WS_WF2 + (size_t)D * DFF * 2 <= WS_ALOW, "d_ws map");
constexpr int CW_TMO = 0, CW_CODE = 1, CW_BAR = 4096;
constexpr int RING_OFF = 0, RING_BYTES = 131072;
constexpr int LDSCTL_OFF = RING_BYTES, MISC_OFF = LDSCTL_OFF + 320;
constexpr int LDS_BYTES = 147456;
#define GAS __attribute__((address_space(1)))
#define LAS __attribute__((address_space(3)))
typedef unsigned short bf16;
typedef unsigned v4u __attribute__((ext_vector_type(4)));
typedef float f32x4 __attribute__((ext_vector_type(4)));
typedef short bf16x8 __attribute__((ext_vector_type(8)));
typedef GAS unsigned gu32;
typedef GAS unsigned long long gu64;
#define RLX_AGENT __ATOMIC_RELAXED, __HIP_MEMORY_SCOPE_AGENT
#define LDS_WAIT() asm volatile("s_waitcnt lgkmcnt(0)" ::: "memory")
#define VM_WAIT() asm volatile("s_waitcnt vmcnt(0)" ::: "memory")
__device__ __forceinline__ unsigned long long rt() { return __builtin_amdgcn_s_memrealtime(); }
__device__ __forceinline__ unsigned f2bf(float f) { unsigned u = __builtin_bit_cast(unsigned, f); return (u + 0x7fffu + ((u >> 16) & 1u)) >> 16; }
__device__ __forceinline__ unsigned pk2(float lo, float hi) { return f2bf(lo) | (f2bf(hi) << 16); }

#define XB_TMO      128
#define XB_XCNT(j)  (256  + 64 * (j))
#define XB_XSUB(j)  (1280 + 64 * (j))
#define XB_XGEN(j)  (2304 + 64 * (j))
#define XB_TOP      3328
#define XB_TOPGEN   3392
#define XCD_BAR_WORDS 3456
#define XB_SPIN_CAP (1u << 18)

__device__ __forceinline__ unsigned xb_ld(unsigned* p)              { return __hip_atomic_load(p, __ATOMIC_RELAXED, __HIP_MEMORY_SCOPE_AGENT); }
__device__ __forceinline__ unsigned xb_add(unsigned* p, unsigned v) { return __hip_atomic_fetch_add(p, v, __ATOMIC_RELAXED, __HIP_MEMORY_SCOPE_AGENT); }
__device__ __forceinline__ unsigned xb_xcc_id() { return (unsigned)__builtin_amdgcn_s_getreg((3 << 11) | 20) & 0xFu; }
#define XB_SPIN(cond, bar) do { unsigned _sp = 0; while (cond) { __builtin_amdgcn_s_sleep(1); \
    if ((++_sp & 255u) == 0u) { if (xb_ld(&(bar)[XB_TMO])) break; if (_sp > XB_SPIN_CAP) { atomicAdd(&(bar)[XB_TMO], 1u); break; } } } } while (0)

struct XcdBarrier {
    unsigned* bar; unsigned x;
    volatile LAS unsigned* st;
};

__device__ __forceinline__ XcdBarrier xcd_barrier_post(unsigned* bar, volatile LAS unsigned* st) {
    XcdBarrier b; b.bar = bar; b.x = xb_xcc_id(); b.st = st;
    if (threadIdx.x == 0) (void)xb_add(&bar[XB_XCNT(b.x)], 1u);
    return b;
}
__device__ __forceinline__ void xcd_barrier_complete(unsigned* bar, unsigned x, unsigned& nloc, unsigned& nx) {
    const unsigned G = gridDim.x * gridDim.y * gridDim.z;
    unsigned sum, cnt, mine, sp = 0u;
    for (;;) {
        sum = 0u; cnt = 0u; mine = 0u;
#pragma unroll
        for (unsigned j = 0; j < 16; ++j) { const unsigned c = xb_ld(&bar[XB_XCNT(j)]); sum += c; cnt += (c > 0u) ? 1u : 0u; mine = (j == x) ? c : mine; }
        if (sum == G) break;
        __builtin_amdgcn_s_sleep(1);
        if ((++sp & 255u) == 0u) { if (xb_ld(&bar[XB_TMO])) break; if (sp > XB_SPIN_CAP) { atomicAdd(&bar[XB_TMO], 1u); break; } }
    }
    nloc = mine > 0u ? mine : 1u; nx = cnt > 0u ? cnt : 1u;
}

__device__ __forceinline__ void xcd_barrier(const XcdBarrier& b) {
    asm volatile("s_waitcnt vmcnt(0)" ::: "memory");
    __syncthreads();
    if (threadIdx.x == 0) {
        unsigned* bar = b.bar;
        __builtin_amdgcn_s_waitcnt(0);
        unsigned nloc = b.st[0], nx = b.st[1];
        if (nloc == 0u) { xcd_barrier_complete(bar, b.x, nloc, nx); b.st[0] = nloc; b.st[1] = nx; }
        const unsigned old = xb_add(&bar[XB_XSUB(b.x)], 1u);
        const unsigned gen = old / nloc;
        if (old + 1u == (gen + 1u) * nloc) {
            __builtin_amdgcn_fence(__ATOMIC_RELEASE, "agent");
            asm volatile("s_waitcnt vmcnt(0)" ::: "memory");
            const unsigned og = xb_add(&bar[XB_TOP], 1u);
            const unsigned tg = og / nx;
            if (og + 1u == (tg + 1u) * nx) xb_add(&bar[XB_TOPGEN], 1u);
            else XB_SPIN(xb_ld(&bar[XB_TOPGEN]) == tg, bar);
            __builtin_amdgcn_fence(__ATOMIC_ACQUIRE, "agent");
            xb_add(&bar[XB_XGEN(b.x)], 1u);
            asm volatile("s_waitcnt vmcnt(0)" ::: "memory");
        } else {
            XB_SPIN(xb_ld(&bar[XB_XGEN(b.x)]) == gen, bar);
            __builtin_amdgcn_fence(__ATOMIC_ACQUIRE, "agent");
            asm volatile("s_waitcnt vmcnt(0)" ::: "memory");
        }
    }
    __syncthreads();
}
static_assert((CW_BAR + XCD_BAR_WORDS) * 4 <= (int)CTL_ZERO_BYTES, "barrier words inside the memset region");
struct Frame {
    LAS unsigned char* lds;
    volatile LAS unsigned* MISC;
    gu32* ctl;
    int tid, lane, wave, G;
    const float *x, *c, *w_ada, *b_ada, *g_mix, *w_in, *conv_w, *conv_b, *ln_g, *ln_b, *w_a2, *b_a2, *gla_g, *w_out, *g_ffn, *w_f1, *w_f2, *w_adaf, *b_adaf, *g_fin;
    float* out; float* modv; float* ALOW; float* DEC; float* KVT;
    bf16 *WA, *WIN, *WOUT, *WF1, *WF2, *XN, *U, *QK, *V, *OG, *Y, *H;
};
__device__ __forceinline__ float wave_sum(float v) {
#pragma unroll
    for (int o = 1; o < 64; o <<= 1) v += __shfl_xor(v, o);
    return v;
}
__device__ __forceinline__ float bf2f(unsigned h) { return __uint_as_float(h << 16); }
__device__ __forceinline__ float sigm_f(float x) { return __builtin_amdgcn_rcpf(1.0f + __expf(-x)); }

__device__ __forceinline__ void p0_mod(Frame& F) {
    LAS float* red = (LAS float*)(F.lds + RING_OFF);
    const int q = F.tid & 7, ks = F.tid >> 3;
    for (int cb = blockIdx.x; cb < NMOD / 32; cb += F.G) {
        const int col0 = cb * 32 + 4 * q;
        const float* W; int ldw, wcol;
        if (col0 < 6144) { W = F.w_ada; ldw = 6144; wcol = col0; } else { W = F.w_adaf; ldw = 2048; wcol = col0 - 6144; }
        f32x4 a0 = {0.f, 0.f, 0.f, 0.f}, a1 = {0.f, 0.f, 0.f, 0.f};
#pragma unroll 8
        for (int kk = 0; kk < 16; ++kk) { const int k = ks * 16 + kk; const f32x4 w = *(const f32x4*)(W + (size_t)k * ldw + wcol);
            const float c0 = F.c[k], c1 = F.c[D + k]; const float s0 = c0 * sigm_f(c0), s1 = c1 * sigm_f(c1); a0 += s0 * w; a1 += s1 * w; }
        *(LAS f32x4*)(red + (ks * 8 + q) * 8) = a0; *(LAS f32x4*)(red + (ks * 8 + q) * 8 + 4) = a1;
        __syncthreads();
        if (F.tid < 64) { const int q2 = F.tid & 7, comp = F.tid >> 3; float s = 0.f;
            for (int k2 = 0; k2 < 64; ++k2) s += red[(k2 * 8 + q2) * 8 + comp];
            const int b = comp >> 2, col = cb * 32 + 4 * q2 + (comp & 3);
            const float bias = (col < 6144) ? F.b_ada[col] : F.b_adaf[col - 6144];
            F.modv[b * NMOD + col] = s + bias; }
        __syncthreads();
    }
}
__device__ __forceinline__ void p0_transpose_item(const float* W, int ldw, int K, bf16* WT, int j0, int src0, int k0, LAS float* scr, int lane) {
#pragma unroll 8
    for (int i = 0; i < 32; ++i) { const int kk = 2 * i + (lane >> 5); scr[kk * 33 + (lane & 31)] = W[(size_t)(k0 + kk) * ldw + src0 + (lane & 31)]; }
    LDS_WAIT(); asm volatile("" ::: "memory");
    const int c = lane & 7;
#pragma unroll
    for (int j = 0; j < 4; ++j) { const int n = (lane >> 3) + 8 * j; const LAS float* s = scr + (8 * c) * 33 + n;
        v4u o; o.x = pk2(s[0 * 33], s[1 * 33]); o.y = pk2(s[2 * 33], s[3 * 33]); o.z = pk2(s[4 * 33], s[5 * 33]); o.w = pk2(s[6 * 33], s[7 * 33]);
        *(GAS v4u*)(WT + (size_t)(j0 + n) * K + k0 + 8 * c) = o; }
    LDS_WAIT(); asm volatile("" ::: "memory");
}
__device__ __forceinline__ void p0_weights(Frame& F) {
    LAS float* scr = (LAS float*)(F.lds + RING_OFF + 16384 + F.wave * 8704);
    const int gw = blockIdx.x * NWAVES + F.wave, NGW = F.G * NWAVES;
    constexpr int I_IN = 16 * (NPROJ / 32), I_OUT = 16 * (D / 32), I_F1 = 16 * (2 * DFF / 32), I_F2 = (DFF / 64) * (D / 32);
    constexpr int NITEMS = I_IN + I_OUT + I_F1 + I_F2;
    for (int it = gw; it < NITEMS; it += NGW) {
        int r = it;
        if (r < I_IN) { const int nblk = NPROJ / 32, kb = r / nblk, jb = r % nblk, j0 = 32 * jb; int src0;
            if (j0 < 1024) { const int pn = j0 >> 8, bj = (j0 >> 7) & 1, i0 = j0 & 127; src0 = bj * 512 + pn * 128 + i0; } else src0 = j0;
            p0_transpose_item(F.w_in, DIN, D, F.WIN, j0, src0, 64 * kb, scr, F.lane); continue; }
        r -= I_IN;
        if (r < I_OUT) { const int nblk = D / 32, kb = r / nblk, jb = r % nblk; p0_transpose_item(F.w_out, D, D, F.WOUT, 32 * jb, 32 * jb, 64 * kb, scr, F.lane); continue; }
        r -= I_OUT;
        if (r < I_F1) { const int nblk = 2 * DFF / 32, kb = r / nblk, jb = r % nblk, j0 = 32 * jb; const int pn = j0 >> 8, bj = (j0 >> 7) & 1, i0 = j0 & 127;
            p0_transpose_item(F.w_f1, 2 * DFF, D, F.WF1, j0, bj * DFF + pn * 128 + i0, 64 * kb, scr, F.lane); continue; }
        r -= I_F1;
        { const int nblk = D / 32, kb = r / nblk, jb = r % nblk; p0_transpose_item(F.w_f2, D, DFF, F.WF2, 32 * jb, 32 * jb, 64 * kb, scr, F.lane); }
    }
    for (int idx = blockIdx.x * (NWAVES * 64) + F.tid; idx < RANK * D; idx += F.G * NWAVES * 64) { const int r = idx & 15, k = idx >> 4; F.WA[r * D + k] = (bf16)f2bf(F.w_in[(size_t)k * DIN + 2560 + r]); }
}
template <bool OUT_BF16>
__device__ __forceinline__ void modnorm_phase(Frame& F, const float* src, const float* g, int sh_off, int sc_off, void* dst) {
    const int gw = blockIdx.x * NWAVES + F.wave, NGW = F.G * NWAVES;
    for (int rg = gw; rg < M / 8; rg += NGW) {
        const int b = (rg * 8) / T; const float* mv = F.modv + b * NMOD;
        f32x4 ca[4], cb[4];
#pragma unroll
        for (int j = 0; j < 4; ++j) { const int c4 = 4 * F.lane + 256 * j; const f32x4 gg = *(const f32x4*)(g + c4), sc = *(const f32x4*)(mv + sc_off + c4); ca[j] = gg * (sc + 1.0f); cb[j] = *(const f32x4*)(mv + sh_off + c4); }
        for (int r = 0; r < 8; ++r) {
            const size_t m = (size_t)rg * 8 + r; const f32x4* xr = (const f32x4*)(src + m * D) + F.lane;
            f32x4 v[4]; float ss = 0.f;
#pragma unroll
            for (int j = 0; j < 4; ++j) { v[j] = xr[64 * j]; ss += (v[j].x * v[j].x + v[j].y * v[j].y) + (v[j].z * v[j].z + v[j].w * v[j].w); }
            const float rstd = 1.0f / sqrtf(wave_sum(ss) * (1.0f / D) + EPS);
#pragma unroll
            for (int j = 0; j < 4; ++j) { const f32x4 y = v[j] * rstd * ca[j] + cb[j];
                if (OUT_BF16) { unsigned long long* o8 = (unsigned long long*)((bf16*)dst + m * D) + F.lane; o8[64 * j] = (unsigned long long)pk2(y.x, y.y) | ((unsigned long long)pk2(y.z, y.w) << 32); }
                else { f32x4* o = (f32x4*)((float*)dst + m * D) + F.lane; o[64 * j] = y; } }
        }
    }
}
__device__ __forceinline__ void p2_alow(Frame& F) {
    LAS f32x4* red = (LAS f32x4*)(F.lds + RING_OFF);
    const int mf = F.wave & 3, kh = F.wave >> 2, fr = F.lane & 15, fq = F.lane >> 4;
    for (int rb = blockIdx.x; rb < M / 64; rb += F.G) {
        const int row0 = rb * 64 + 16 * mf;
        const bf16* ap = F.XN + (size_t)(row0 + fr) * D + kh * 512 + 8 * fq; const bf16* bp = F.WA + (size_t)fr * D + kh * 512 + 8 * fq;
        f32x4 acc = {0.f, 0.f, 0.f, 0.f};
#pragma unroll 4
        for (int s = 0; s < 16; ++s) { const bf16x8 a = *(const bf16x8*)(ap + 32 * s), b = *(const bf16x8*)(bp + 32 * s); acc = __builtin_amdgcn_mfma_f32_16x16x32_bf16(a, b, acc, 0, 0, 0); }
        if (kh == 1) red[mf * 64 + F.lane] = acc;
        __syncthreads();
        if (kh == 0) { acc += red[mf * 64 + F.lane];
#pragma unroll
            for (int r = 0; r < 4; ++r) F.ALOW[(size_t)(row0 + 4 * fq + r) * RANK + fr] = acc[r]; }
        __syncthreads();
    }
}
__device__ __forceinline__ void gla1_unit(Frame& F, int uidx) {
    const int bh = uidx >> 7, cch = uidx & 127, b = bh >> 2, h = bh & 3; const int m0 = b * T + cch * 64;
    LAS float* AL = (LAS float*)(F.lds + RING_OFF);
    LAS float* SEG = (LAS float*)(F.lds + RING_OFF + 4096);
    LAS bf16* KT = (LAS bf16*)(F.lds + RING_OFF + 8192);
    LAS bf16* VT = (LAS bf16*)(F.lds + RING_OFF + 20480);
    const int tid = F.tid, d = tid & 63, seg = tid >> 6, hd = h * HK + d;
    if (tid < 256) *(LAS f32x4*)(AL + tid * 4) = *(const f32x4*)(F.ALOW + (size_t)m0 * RANK + tid * 4);
    float wa[16];
#pragma unroll
    for (int r = 0; r < 16; ++r) wa[r] = F.w_a2[r * DK + hd];
    const float ba = F.b_a2[hd];
    __syncthreads();
    float cum[8]; float run = 0.f;
#pragma unroll
    for (int i = 0; i < 8; ++i) { const int t = seg * 8 + i; float z = ba;
#pragma unroll
        for (int r4 = 0; r4 < 4; ++r4) { const f32x4 a = *(const LAS f32x4*)(AL + t * 16 + 4 * r4); z += a.x * wa[4 * r4] + a.y * wa[4 * r4 + 1] + a.z * wa[4 * r4 + 2] + a.w * wa[4 * r4 + 3]; }
        const float la = (fminf(z, 0.f) - log1pf(expf(-fabsf(z)))) * (1.0f / 16.0f); run += la; cum[i] = run; }
    SEG[seg * 64 + d] = run;
    __syncthreads();
    float pre = 0.f, tot = 0.f;
#pragma unroll
    for (int s = 0; s < 8; ++s) { const float v = SEG[s * 64 + d]; tot += v; pre += (s < seg) ? v : 0.f; }
    { bf16* qkp = F.QK + (size_t)m0 * 512 + hd; unsigned kh[8];
#pragma unroll
        for (int i = 0; i < 8; ++i) { const int t = seg * 8 + i; const float cm = cum[i] + pre; bf16* p = qkp + (size_t)t * 512;
            const float qv = bf2f(p[0]), kv = bf2f(p[256]);
            p[0] = (bf16)f2bf(qv * 0.125f * expf(cm)); p[256] = (bf16)f2bf(kv * expf(-cm)); kh[i] = f2bf(kv * expf(tot - cm)); }
        v4u pk; pk.x = kh[0] | (kh[1] << 16); pk.y = kh[2] | (kh[3] << 16); pk.z = kh[4] | (kh[5] << 16); pk.w = kh[6] | (kh[7] << 16);
        *(LAS v4u*)(KT + d * 72 + seg * 8) = pk;
        if (seg == 0) F.DEC[(size_t)uidx * 64 + d] = expf(tot); }
    { const int e = tid & 127, tq = tid >> 7; const bf16* vp = F.V + (size_t)(m0 + tq * 16) * 512 + h * HV + e; unsigned vv[16];
#pragma unroll
        for (int i = 0; i < 16; ++i) vv[i] = vp[(size_t)i * 512];
        v4u p0, p1; p0.x = vv[0] | (vv[1] << 16); p0.y = vv[2] | (vv[3] << 16); p0.z = vv[4] | (vv[5] << 16); p0.w = vv[6] | (vv[7] << 16);
        p1.x = vv[8] | (vv[9] << 16); p1.y = vv[10] | (vv[11] << 16); p1.z = vv[12] | (vv[13] << 16); p1.w = vv[14] | (vv[15] << 16);
        *(LAS v4u*)(VT + e * 72 + tq * 16) = p0; *(LAS v4u*)(VT + e * 72 + tq * 16 + 8) = p1; }
    __syncthreads();
    { const int w = F.wave, fr = F.lane & 15, fq = F.lane >> 4; bf16x8 a[2];
#pragma unroll
        for (int s = 0; s < 2; ++s) a[s] = *(const LAS bf16x8*)(VT + (16 * w + fr) * 72 + 32 * s + 8 * fq);
        float* outp = F.KVT + (size_t)uidx * 8192;
#pragma unroll
        for (int dt = 0; dt < 4; ++dt) { f32x4 acc = {0.f, 0.f, 0.f, 0.f};
#pragma unroll
            for (int s = 0; s < 2; ++s) { const bf16x8 kb = *(const LAS bf16x8*)(KT + (16 * dt + fr) * 72 + 32 * s + 8 * fq); acc = __builtin_amdgcn_mfma_f32_16x16x32_bf16(a[s], kb, acc, 0, 0, 0); }
#pragma unroll
            for (int r = 0; r < 4; ++r) outp[(16 * w + 4 * fq + r) * 64 + 16 * dt + fr] = acc[r]; } }
}
__device__ __forceinline__ void p4_scan(Frame& F) {
    if (F.tid < 256)
    for (int cb = blockIdx.x; cb < 256; cb += F.G) {
        const int bh = cb >> 5, idx = (cb & 31) * 256 + F.tid, d = idx & 63;
        float* p = F.KVT + (size_t)bh * 128 * 8192 + idx; const float* dp = F.DEC + (size_t)bh * 128 * 64 + d;
        float S = 0.f;
        for (int c0 = 0; c0 < 128; c0 += 8) { float kv[8], dc[8];
#pragma unroll
            for (int i = 0; i < 8; ++i) { kv[i] = p[(size_t)(c0 + i) * 8192]; dc[i] = dp[(c0 + i) * 64]; }
#pragma unroll
            for (int i = 0; i < 8; ++i) { p[(size_t)(c0 + i) * 8192] = S; S = dc[i] * S + kv[i]; } }
    }
}
typedef float f32x2 __attribute__((ext_vector_type(2)));
template <int S> __device__ __forceinline__ void conv_steps(f32x2 (&acc)[32], const f32x2 (&w)[CK], const bf16* up, int tbfirst) {
    if constexpr (S < 32 + CK - 1) {
        f32x2 in = {0.f, 0.f};
        if (tbfirst + S >= 0) { const unsigned raw = *(const unsigned*)(up + (ptrdiff_t)S * DCONV); in.x = bf2f(raw & 0xffffu); in.y = bf2f(raw >> 16); }
#pragma unroll
        for (int o = 0; o < 32; ++o) { const int j = S - o; if (j >= 0 && j < CK) acc[o] += w[j] * in; }
        conv_steps<S + 1>(acc, w, up, tbfirst);
    }
}
__device__ __forceinline__ void conv_unit(Frame& F, int unit) {
    const int m0 = unit * 64, tb0 = m0 & (T - 1); const int cp = F.tid & 255, th = F.tid >> 8;
    f32x2 w[CK];
#pragma unroll
    for (int j = 0; j < CK; ++j) w[j] = *(const f32x2*)(F.conv_w + j * DCONV + 2 * cp);
    const f32x2 bias = *(const f32x2*)(F.conv_b + 2 * cp);
    f32x2 acc[32];
#pragma unroll
    for (int o = 0; o < 32; ++o) acc[o] = bias;
    const int tfirst = th * 32 - (CK - 1);
    conv_steps<0>(acc, w, F.U + ((ptrdiff_t)m0 + tfirst) * DCONV + 2 * cp, tb0 + tfirst);
    LAS float* C = (LAS float*)(F.lds + RING_OFF);
#pragma unroll
    for (int o = 0; o < 32; ++o) *(LAS f32x2*)(C + (th * 32 + o) * DCONV + 2 * cp) = acc[o];
    __syncthreads();
    for (int rr = 0; rr < 8; ++rr) { const int t = 8 * F.wave + rr; const size_t m = (size_t)m0 + t;
        f32x4 v[2]; float s1 = 0.f;
#pragma unroll
        for (int j = 0; j < 2; ++j) { v[j] = *(const LAS f32x4*)(C + t * DCONV + 4 * F.lane + 256 * j); s1 += (v[j].x + v[j].y) + (v[j].z + v[j].w); }
        const float mean = wave_sum(s1) * (1.0f / DCONV); float s2 = 0.f;
#pragma unroll
        for (int j = 0; j < 2; ++j) { v[j] = v[j] - mean; s2 += (v[j].x * v[j].x + v[j].y * v[j].y) + (v[j].z * v[j].z + v[j].w * v[j].w); }
        const float rstd = 1.0f / sqrtf(wave_sum(s2) * (1.0f / DCONV) + EPS);
#pragma unroll
        for (int j = 0; j < 2; ++j) { const int c4 = 4 * F.lane + 256 * j; const f32x4 gm = *(const f32x4*)(F.ln_g + c4), bt = *(const f32x4*)(F.ln_b + c4);
            f32x4 y = v[j] * rstd * gm + bt;
#pragma unroll
            for (int i = 0; i < 4; ++i) y[i] *= sigm_f(y[i]);
            *(unsigned long long*)(F.Y + m * D + c4) = (unsigned long long)pk2(y.x, y.y) | ((unsigned long long)pk2(y.z, y.w) << 32); } }
    __syncthreads();
}
__device__ __forceinline__ void gla3_unit(Frame& F, int uidx) {
    const int bh = uidx >> 7, cch = uidx & 127, b = bh >> 2, h = bh & 3; const int m0 = b * T + cch * 64;
    LAS bf16* QT = (LAS bf16*)(F.lds + RING_OFF);
    LAS bf16* KT = (LAS bf16*)(F.lds + RING_OFF + 9216);
    LAS bf16* VT = (LAS bf16*)(F.lds + RING_OFF + 18432);
    LAS bf16* ST = (LAS bf16*)(F.lds + RING_OFF + 36864);
    LAS bf16* PT = (LAS bf16*)(F.lds + RING_OFF + 55296);
    LAS float* OT = (LAS float*)(F.lds + RING_OFF + 64512);
    const int tid = F.tid;
    { const int row = tid >> 3, ch = tid & 7; const bf16* p = F.QK + (size_t)(m0 + row) * 512 + h * HK + ch * 8;
        const v4u q = *(const v4u*)p, k = *(const v4u*)(p + 256); *(LAS v4u*)(QT + row * 72 + ch * 8) = q; *(LAS v4u*)(KT + row * 72 + ch * 8) = k; }
    { const int e = tid & 127, tq = tid >> 7; const bf16* vp = F.V + (size_t)(m0 + tq * 16) * 512 + h * HV + e; unsigned vv[16];
#pragma unroll
        for (int i = 0; i < 16; ++i) vv[i] = vp[(size_t)i * 512];
        v4u p0, p1; p0.x = vv[0] | (vv[1] << 16); p0.y = vv[2] | (vv[3] << 16); p0.z = vv[4] | (vv[5] << 16); p0.w = vv[6] | (vv[7] << 16);
        p1.x = vv[8] | (vv[9] << 16); p1.y = vv[10] | (vv[11] << 16); p1.z = vv[12] | (vv[13] << 16); p1.w = vv[14] | (vv[15] << 16);
        *(LAS v4u*)(VT + e * 72 + tq * 16) = p0; *(LAS v4u*)(VT + e * 72 + tq * 16 + 8) = p1; }
    { const int e = tid >> 2, dq = tid & 3; const f32x4* sp = (const f32x4*)(F.KVT + (size_t)uidx * 8192 + e * 64 + dq * 16);
        const f32x4 s0 = sp[0], s1 = sp[1], s2 = sp[2], s3 = sp[3];
        v4u p0, p1; p0.x = pk2(s0.x, s0.y); p0.y = pk2(s0.z, s0.w); p0.z = pk2(s1.x, s1.y); p0.w = pk2(s1.z, s1.w); p1.x = pk2(s2.x, s2.y); p1.y = pk2(s2.z, s2.w); p1.z = pk2(s3.x, s3.y); p1.w = pk2(s3.z, s3.w);
        *(LAS v4u*)(ST + e * 72 + dq * 16) = p0; *(LAS v4u*)(ST + e * 72 + dq * 16 + 8) = p1; }
    __syncthreads();
    const int w = F.wave, fr = F.lane & 15, fq = F.lane >> 4, it = w >> 1;
    bf16x8 qa[2];
#pragma unroll
    for (int s = 0; s < 2; ++s) qa[s] = *(const LAS bf16x8*)(QT + (16 * it + fr) * 72 + 32 * s + 8 * fq);
#pragma unroll
    for (int jj = 0; jj < 2; ++jj) { const int jt = (w & 1) * 2 + jj; f32x4 acc = {0.f, 0.f, 0.f, 0.f};
#pragma unroll
        for (int s = 0; s < 2; ++s) { const bf16x8 kb = *(const LAS bf16x8*)(KT + (16 * jt + fr) * 72 + 32 * s + 8 * fq); acc = __builtin_amdgcn_mfma_f32_16x16x32_bf16(qa[s], kb, acc, 0, 0, 0); }
#pragma unroll
        for (int r = 0; r < 4; ++r) { const int i = 16 * it + 4 * fq + r, j = 16 * jt + fr; PT[i * 72 + j] = (bf16)f2bf((j <= i) ? acc[r] : 0.f); } }
    __syncthreads();
    { bf16x8 pa[2];
#pragma unroll
        for (int s = 0; s < 2; ++s) pa[s] = *(const LAS bf16x8*)(PT + (16 * it + fr) * 72 + 32 * s + 8 * fq);
#pragma unroll
        for (int ee = 0; ee < 4; ++ee) { const int et = (w & 1) * 4 + ee; f32x4 acc = {0.f, 0.f, 0.f, 0.f};
#pragma unroll
            for (int s = 0; s < 2; ++s) { const bf16x8 sb = *(const LAS bf16x8*)(ST + (16 * et + fr) * 72 + 32 * s + 8 * fq); acc = __builtin_amdgcn_mfma_f32_16x16x32_bf16(qa[s], sb, acc, 0, 0, 0); }
#pragma unroll
            for (int s = 0; s < 2; ++s) { const bf16x8 vb = *(const LAS bf16x8*)(VT + (16 * et + fr) * 72 + 32 * s + 8 * fq); acc = __builtin_amdgcn_mfma_f32_16x16x32_bf16(pa[s], vb, acc, 0, 0, 0); }
#pragma unroll
            for (int r = 0; r < 4; ++r) OT[(16 * it + 4 * fq + r) * 132 + 16 * et + fr] = acc[r]; } }
    __syncthreads();
    { const f32x2 gg = *(const f32x2*)(F.gla_g + 2 * F.lane);
        for (int rr = 0; rr < 8; ++rr) { const int i = 8 * w + rr; const size_t m = (size_t)m0 + i;
            const f32x2 o = *(const LAS f32x2*)(OT + i * 132 + 2 * F.lane);
            const float rstd = 1.0f / sqrtf(wave_sum(o.x * o.x + o.y * o.y) * (1.0f / HV) + EPS);
            const unsigned ogr = *(const unsigned*)(F.OG + m * 512 + h * HV + 2 * F.lane); const float g0 = bf2f(ogr & 0xffffu), g1 = bf2f(ogr >> 16);
            const float y0 = o.x * rstd * gg.x * (g0 * sigm_f(g0)), y1 = o.y * rstd * gg.y * (g1 * sigm_f(g1));
            *(unsigned*)(F.Y + m * D + DCONV + h * HV + 2 * F.lane) = pk2(y0, y1); } }
}
struct Args { const float* in[20]; float* out; unsigned char* ws; int ph_lo, ph_hi, li, pad; };
__global__ void __launch_bounds__(NWAVES * 64, 2) hyb_fwd(Args args) {
    extern __shared__ __attribute__((aligned(16))) unsigned char lds[];
    Frame F;
    F.lds = (LAS unsigned char*)lds;
    F.MISC = (volatile LAS unsigned*)(F.lds + MISC_OFF);
    F.tid = threadIdx.x; F.lane = F.tid & 63; F.wave = __builtin_amdgcn_readfirstlane(F.tid >> 6);
    F.G = gridDim.x;
    unsigned char* ws = args.ws;
    F.ctl = (gu32*)(ws + WS_CTL);
    F.x = args.in[0]; F.c = args.in[1]; F.w_ada = args.in[2]; F.b_ada = args.in[3]; F.g_mix = args.in[4]; F.w_in = args.in[5]; F.conv_w = args.in[6]; F.conv_b = args.in[7];
    F.ln_g = args.in[8]; F.ln_b = args.in[9]; F.w_a2 = args.in[10]; F.b_a2 = args.in[11]; F.gla_g = args.in[12]; F.w_out = args.in[13]; F.g_ffn = args.in[14];
    F.w_f1 = args.in[15]; F.w_f2 = args.in[16]; F.w_adaf = args.in[17]; F.b_adaf = args.in[18]; F.g_fin = args.in[19];
    F.out = args.out; F.modv = (float*)(ws + WS_MOD); F.ALOW = (float*)(ws + WS_ALOW); F.DEC = (float*)(ws + WS_DEC); F.KVT = (float*)(ws + WS_KV);
    F.WA = (bf16*)(ws + WS_WA); F.WIN = (bf16*)(ws + WS_WIN); F.WOUT = (bf16*)(ws + WS_WOUT); F.WF1 = (bf16*)(ws + WS_WF1); F.WF2 = (bf16*)(ws + WS_WF2);
    F.XN = (bf16*)(ws + WS_XN); F.U = (bf16*)(ws + WS_U); F.QK = (bf16*)(ws + WS_QK); F.V = (bf16*)(ws + WS_V); F.OG = (bf16*)(ws + WS_OG); F.Y = (bf16*)(ws + WS_Y); F.H = (bf16*)(ws + WS_H);
    for (int u = F.tid; u < (LDS_BYTES - LDSCTL_OFF) / 4; u += NWAVES * 64) ((LAS unsigned*)(F.lds + LDSCTL_OFF))[u] = 0u;
    __syncthreads();
    XcdBarrier bar; bar.bar = (unsigned*)(F.ctl + CW_BAR); bar.x = 0; bar.st = nullptr;
    if (N_LAUNCHES == 1) bar = xcd_barrier_post((unsigned*)(F.ctl + CW_BAR), F.MISC + 8);
#define GRID_BAR() do { if (N_LAUNCHES == 1) xcd_barrier(bar); } while (0)
    const int lo = args.ph_lo, hi = args.ph_hi;
#define IN(k) (lo <= (k) && (k) < hi)
#define BOTH(k) (IN(k) && IN((k) + 1))

    if (IN(0)) { p0_mod(F); p0_weights(F); if (BOTH(0)) GRID_BAR(); }
    if (IN(1)) { modnorm_phase<true>(F, F.x, F.g_mix, 0, 1024, F.XN); if (BOTH(1)) GRID_BAR(); }
    if (IN(2)) {
        p2_alow(F);
        pg8::Gemm g{F.XN, F.WIN, M, NPROJ, D}; pg8::StaticOrder S; S.init(M, NPROJ, F.G, (int)blockIdx.x);
        pg8::EpiProj E{F.U, F.QK, (size_t)(WS_V - WS_QK) / 2};
        static_assert(WS_V - WS_QK == WS_OG - WS_V, "QK, V, OG equally spaced");
        pg8::gemm_phase<pg8::EpiProj, pg8::StaticOrder, true, true>(F.lds + RING_OFF, g, S, E);
        if (BOTH(2)) GRID_BAR();
    }
    if (IN(3)) { for (int u = blockIdx.x; u < 1024; u += F.G) gla1_unit(F, u); if (BOTH(3)) GRID_BAR(); }
    if (IN(4)) { p4_scan(F); for (int u = blockIdx.x; u < M / 64; u += F.G) conv_unit(F, u); if (BOTH(4)) GRID_BAR(); }
    if (IN(5)) { for (int u = blockIdx.x; u < 1024; u += F.G) gla3_unit(F, u); if (BOTH(5)) GRID_BAR(); }
    if (IN(6)) {
        pg8::Gemm g{F.Y, F.WOUT, M, D, D}; pg8::StaticOrder S; S.init(M, D, F.G, (int)blockIdx.x);
        pg8::EpiResid E{F.x, F.out, F.modv + 2048, NMOD};
        pg8::gemm_phase<pg8::EpiResid, pg8::StaticOrder, true, true>(F.lds + RING_OFF, g, S, E);
        if (BOTH(6)) GRID_BAR();
    }
    if (IN(7)) { modnorm_phase<true>(F, F.out, F.g_ffn, 3072, 4096, F.XN); if (BOTH(7)) GRID_BAR(); }
    if (IN(8)) {
        pg8::Gemm g{F.XN, F.WF1, M, 2 * DFF, D}; pg8::StaticOrder S; S.init(M, 2 * DFF, F.G, (int)blockIdx.x);
        pg8::EpiSwiGLU E{F.H, DFF};
        pg8::gemm_phase<pg8::EpiSwiGLU, pg8::StaticOrder, true, true>(F.lds + RING_OFF, g, S, E);
        if (BOTH(8)) GRID_BAR();
    }
    if (IN(9)) {
        pg8::Gemm g{F.H, F.WF2, M, D, DFF}; pg8::StaticOrder S; S.init(M, D, F.G, (int)blockIdx.x);
        pg8::EpiResid E{F.out, F.out, F.modv + 5120, NMOD};
        pg8::gemm_phase<pg8::EpiResid, pg8::StaticOrder, true, true>(F.lds + RING_OFF, g, S, E);
        if (BOTH(9)) GRID_BAR();
    }
    if (IN(10)) { modnorm_phase<false>(F, F.out, F.g_fin, 6144, 7168, F.out); }
#undef IN
#undef BOTH
}

extern "C" void kernel_launch(void* const* d_in, const int* in_sizes, int n_in, void* d_out, int out_size, void* d_ws, size_t ws_size, hipStream_t stream) {
    static int grid = 0;
    if (grid == 0) {
        if (n_in != 20 || in_sizes[0] != M * D || out_size != M * D || ws_size < WS_END) { fprintf(stderr, "kernel_launch: unexpected shapes (n_in %d, in0 %d, out %d, ws %zu); nothing launched\n", n_in, n_in > 0 ? in_sizes[0] : -1, out_size, ws_size); grid = -1; return; }
        int dev = 0, cus = 0, per_cu = 0;
        if (hipGetDevice(&dev) != hipSuccess || hipDeviceGetAttribute(&cus, hipDeviceAttributeMultiprocessorCount, dev) != hipSuccess) { grid = -1; return; }
        if (hipFuncSetAttribute((const void*)hyb_fwd, hipFuncAttributeMaxDynamicSharedMemorySize, LDS_BYTES) != hipSuccess) { fprintf(stderr, "kernel_launch: hipFuncSetAttribute failed\n"); grid = -1; return; }
        if (hipOccupancyMaxActiveBlocksPerMultiprocessor(&per_cu, (const void*)hyb_fwd, NWAVES * 64, LDS_BYTES) != hipSuccess || per_cu < 1)
            fprintf(stderr, "kernel_launch: note: occupancy query reports %d workgroups per CU\n", per_cu);
        (void)hipGetLastError();
        grid = cus;
        if (grid > 256) grid = 256;
    }
    if (grid < 0) return;
    if (hipMemsetAsync((char*)d_ws + WS_CTL, 0, CTL_ZERO_BYTES, stream) != hipSuccess) { fprintf(stderr, "kernel_launch: hipMemsetAsync failed\n"); return; }
    Args a{};
    for (int i = 0; i < 20; ++i) a.in[i] = (const float*)d_in[i];
    a.out = (float*)d_out; a.ws = (unsigned char*)d_ws;
    for (int li = 0; li < N_LAUNCHES; ++li) {
        a.ph_lo = (N_LAUNCHES == 1) ? 0 : li; a.ph_hi = (N_LAUNCHES == 1) ? N_PHASES : li + 1; a.li = li;
        hipLaunchKernelGGL(hyb_fwd, dim3(grid), dim3(NWAVES * 64), LDS_BYTES, stream, a);
        const hipError_t le = hipPeekAtLastError();
        if (le != hipSuccess) { fprintf(stderr, "kernel_launch: launch %d failed: %s\n", li, hipGetErrorName(le)); break; }
    }
}
```
